# Optimizing an MI355X kernel written in HIP

```python
import jax, jax.numpy as jnp
from jax import lax
import numpy as np

D_MODEL = 1024
BATCH = 4
SEQ = 4096
DEPTH = 4

D_MIX = D_MODEL
D_POOL = D_MIX // 2
POOL_WINDOWS = (2, 4, 8, 16)
N_POOL_GROUPS = len(POOL_WINDOWS)
POOL_GROUP = D_POOL // N_POOL_GROUPS
D_CONV = D_MIX - D_POOL
CONV_WIDTH = 3
D_PROJ = D_POOL + 3 * D_CONV

N_EXPERTS = 16
N_EXPERT_GROUPS = 4
EXPERTS_PER_GROUP = N_EXPERTS // N_EXPERT_GROUPS
TOP_K = 2
D_EXPERT = D_MODEL // 2
EXPERT_BLOCK = 128

ALPHA = float((2 * DEPTH) ** 0.25)
BETA = float((8 * DEPTH) ** -0.25)
LN_EPS = 1e-5

kernel_name = "hybrid_pool_conv_grouped_moe_deepnorm"


def layer_norm(x, g, b):
    xf = x.astype(jnp.float32)
    mu = jnp.mean(xf, axis=-1, keepdims=True)
    xc = xf - mu
    var = jnp.mean(xc * xc, axis=-1, keepdims=True)
    return (xc * lax.rsqrt(var + LN_EPS) * g + b).astype(x.dtype)


def causal_multiscale_pool(v, pool_w, pool_scale):
    bsz, s, _ = v.shape
    vf = v.astype(jnp.float32)
    csum = jnp.cumsum(vf, axis=1)
    n_avail = jnp.arange(1, s + 1, dtype=jnp.float32)
    outs = []
    for g, win in enumerate(POOL_WINDOWS):
        sl = slice(g * POOL_GROUP, (g + 1) * POOL_GROUP)
        cg = csum[..., sl]
        prev = jnp.pad(cg, ((0, 0), (win, 0), (0, 0)))[:, :s]
        mean = (cg - prev) / jnp.minimum(n_avail, float(win))[None, :, None]
        outs.append(mean - vf[..., sl])
    pooled = jnp.stack(outs, axis=2).astype(v.dtype)
    mixed = jnp.einsum("bsgc,gcd->bsgd", pooled, pool_w).reshape(bsz, s, D_POOL)
    return mixed * pool_scale


def gated_short_conv(gate_b, gate_c, u, conv_w, conv_b):
    z = gate_c * u
    y = lax.conv_general_dilated(
        z, conv_w[:, None, :], window_strides=(1,), padding=[(CONV_WIDTH - 1, 0)],
        dimension_numbers=("NWC", "WIO", "NWC"), feature_group_count=D_CONV)
    return gate_b * (y + conv_b)


def hybrid_mixer(h, w_in, pool_w, pool_scale, conv_w, conv_b, w_out):
    proj = h @ w_in
    v = proj[..., :D_POOL]
    gb = proj[..., D_POOL:D_POOL + D_CONV]
    gc = proj[..., D_POOL + D_CONV:D_POOL + 2 * D_CONV]
    u = proj[..., D_POOL + 2 * D_CONV:]
    pool_out = causal_multiscale_pool(v, pool_w, pool_scale)
    conv_out = gated_short_conv(gb, gc, u, conv_w, conv_b)
    return jnp.concatenate([pool_out, conv_out], axis=-1) @ w_out


def grouped_moe(x, w_router, router_bias, w1, w3, w2):
    t, d = x.shape
    probs = jax.nn.softmax((x @ w_router).astype(jnp.float32), axis=-1)
    sel = probs + router_bias.astype(jnp.float32)
    grp_score = lax.top_k(sel.reshape(t, N_EXPERT_GROUPS, EXPERTS_PER_GROUP), 2)[0].sum(-1)
    gidx = jnp.argmax(grp_score, axis=-1)
    gmask = jnp.arange(N_EXPERT_GROUPS)[None, :] == gidx[:, None]
    emask = jnp.repeat(gmask, EXPERTS_PER_GROUP, axis=1)
    _, eidx = lax.top_k(jnp.where(emask, sel, -jnp.inf), TOP_K)
    gate = jnp.take_along_axis(probs, eidx, axis=-1)
    gate = gate / jnp.sum(gate, axis=-1, keepdims=True)

    m = t * TOP_K
    flat_e = eidx.reshape(m).astype(jnp.int32)
    flat_tok = jnp.arange(m, dtype=jnp.int32) // TOP_K
    order = jnp.argsort(flat_e, stable=True)
    e_sorted = flat_e[order]
    counts = jnp.bincount(flat_e, length=N_EXPERTS)
    starts = jnp.cumsum(counts) - counts
    padded = ((counts + EXPERT_BLOCK - 1) // EXPERT_BLOCK) * EXPERT_BLOCK
    pend = jnp.cumsum(padded)
    pstarts = pend - padded
    rank = jnp.arange(m, dtype=jnp.int32) - starts[e_sorted]
    dest_sorted = (pstarts[e_sorted] + rank).astype(jnp.int32)
    dest = jnp.zeros((m,), jnp.int32).at[order].set(dest_sorted)
    n_rows = ((m + EXPERT_BLOCK - 1) // EXPERT_BLOCK + N_EXPERTS) * EXPERT_BLOCK
    n_blocks = n_rows // EXPERT_BLOCK
    xbuf = jnp.zeros((n_rows, d), x.dtype).at[dest].set(x[flat_tok])
    blk_start = jnp.arange(n_blocks, dtype=jnp.int32) * EXPERT_BLOCK
    blk_e = jnp.minimum(jnp.searchsorted(pend, blk_start, side="right"), N_EXPERTS - 1)

    def expert_block(args):
        xb, e = args
        hid = jax.nn.silu(xb @ w1[e]) * (xb @ w3[e])
        return hid @ w2[e]

    ybuf = lax.map(expert_block, (xbuf.reshape(n_blocks, EXPERT_BLOCK, d), blk_e))
    ybuf = ybuf.reshape(n_rows, d)
    y = ybuf[dest].reshape(t, TOP_K, d) * gate[..., None].astype(x.dtype)
    return jnp.sum(y, axis=1)


def setup_inputs(seed: int = 0) -> dict:
    key = jax.random.key(seed)
    ks = jax.random.split(key, 20)
    f32 = jnp.float32
    nrm = lambda k, shape: jax.random.normal(k, shape, f32)
    return {
        "x": nrm(ks[0], (BATCH, SEQ, D_MODEL)),
        "ln_in_g": 1.0 + 0.02 * nrm(ks[1], (D_MODEL,)),
        "ln_in_b": 0.02 * nrm(ks[2], (D_MODEL,)),
        "w_in": nrm(ks[3], (DEPTH, D_MODEL, D_PROJ)) * D_MODEL ** -0.5,
        "pool_w": nrm(ks[4], (DEPTH, N_POOL_GROUPS, POOL_GROUP, POOL_GROUP)) * POOL_GROUP ** -0.5,
        "pool_scale": 1.0 + 0.1 * nrm(ks[5], (DEPTH, D_POOL)),
        "conv_w": nrm(ks[6], (DEPTH, CONV_WIDTH, D_CONV)) * CONV_WIDTH ** -0.5,
        "conv_b": 0.02 * nrm(ks[7], (DEPTH, D_CONV)),
        "w_out": nrm(ks[8], (DEPTH, D_MIX, D_MODEL)) * (D_MIX ** -0.5 * BETA),
        "ln1_g": 1.0 + 0.02 * nrm(ks[9], (DEPTH, D_MODEL)),
        "ln1_b": 0.02 * nrm(ks[10], (DEPTH, D_MODEL)),
        "w_router": nrm(ks[11], (D_MODEL, N_EXPERTS)) * D_MODEL ** -0.5,
        "router_bias": 0.01 * nrm(ks[12], (N_EXPERTS,)),
        "exp_w1": nrm(ks[13], (DEPTH, N_EXPERTS, D_MODEL, D_EXPERT)) * D_MODEL ** -0.5,
        "exp_w3": nrm(ks[14], (DEPTH, N_EXPERTS, D_MODEL, D_EXPERT)) * D_MODEL ** -0.5,
        "exp_w2": nrm(ks[15], (DEPTH, N_EXPERTS, D_EXPERT, D_MODEL)) * (D_EXPERT ** -0.5 * BETA),
        "ln2_g": 1.0 + 0.02 * nrm(ks[16], (DEPTH, D_MODEL)),
        "ln2_b": 0.02 * nrm(ks[17], (DEPTH, D_MODEL)),
    }


def reference(x, ln_in_g, ln_in_b, w_in, pool_w, pool_scale, conv_w, conv_b, w_out,
              ln1_g, ln1_b, w_router, router_bias, exp_w1, exp_w3, exp_w2, ln2_g, ln2_b):
    bsz, s, d = x.shape
    h = layer_norm(x, ln_in_g, ln_in_b)
    for l in range(DEPTH):
        mix = hybrid_mixer(h, w_in[l], pool_w[l], pool_scale[l], conv_w[l], conv_b[l], w_out[l])
        h = layer_norm(ALPHA * h + mix, ln1_g[l], ln1_b[l])
        ffn = grouped_moe(h.reshape(bsz * s, d), w_router, router_bias,
                          exp_w1[l], exp_w3[l], exp_w2[l]).reshape(bsz, s, d)
        h = layer_norm(ALPHA * h + ffn, ln2_g[l], ln2_b[l])
    return h
```

```cpp
#include <hip/hip_runtime.h>
#include <hip/hip_cooperative_groups.h>
#include <cstdio>
#include <cstdint>

#ifndef MK_ONE_LAUNCH
#define MK_ONE_LAUNCH 0
#endif

#define GAS __attribute__((address_space(1)))
#define LAS __attribute__((address_space(3)))
typedef unsigned short bf16;
typedef unsigned v4u __attribute__((ext_vector_type(4)));
typedef unsigned v2u __attribute__((ext_vector_type(2)));
typedef float f32x4 __attribute__((ext_vector_type(4)));
typedef float f32x2 __attribute__((ext_vector_type(2)));
typedef short bf16x8 __attribute__((ext_vector_type(8)));
typedef int i32x4 __attribute__((ext_vector_type(4)));
#define RLX_AGENT __ATOMIC_RELAXED, __HIP_MEMORY_SCOPE_AGENT
#define LDS_WAIT() asm volatile("s_waitcnt lgkmcnt(0)" ::: "memory")
#define VM_WAIT() asm volatile("s_waitcnt vmcnt(0)" ::: "memory")

constexpr int T = 16384, D = 1024, DP = 2048, NL = 4, NE = 16, FF = 512, SEQ = 4096, NCLS = 24;
constexpr float ALPHA = 1.6817928305074292f, LN_EPS = 1e-5f;
constexpr int NWAVES = 8, NTHREADS = 512;
constexpr int MAXMT = 96;

constexpr size_t MiB = 1u << 20;
constexpr size_t WS_CTL = 0, CTL_ZERO_BYTES = 1 * MiB;
constexpr size_t WS_WIN = 1 * MiB;
constexpr size_t WS_WCAT = 17 * MiB;
constexpr size_t WS_W13 = 25 * MiB;
constexpr size_t WS_W2 = 153 * MiB;
constexpr size_t WS_HB = 217 * MiB;
constexpr size_t WS_PROJ = 249 * MiB;
constexpr size_t WS_MIX = 313 * MiB;
constexpr size_t WS_HID = 345 * MiB;
constexpr size_t WS_TOKINFO = 393 * MiB;
constexpr size_t WS_ROWINFO = 394 * MiB;
constexpr size_t WS_TILES = 395 * MiB;
constexpr size_t WS_END = 396 * MiB;
constexpr int CW_BAR = 4096;
constexpr int CW_HIST = 16384;
constexpr int CW_CURS = 16384 + 64 * NL;

constexpr int RING_BYTES = 131072;
constexpr int LDSCTL_OFF = RING_BYTES, MISC_OFF = LDSCTL_OFF + 320;
constexpr int GTAB_OFF = RING_BYTES + 1024;
constexpr int LDS_BYTES = 147456;

__device__ __forceinline__ unsigned f2bf(float f) { unsigned u = __builtin_bit_cast(unsigned, f); return (u + 0x7fffu + ((u >> 16) & 1u)) >> 16; }
__device__ __forceinline__ unsigned pk2(float lo, float hi) { return f2bf(lo) | (f2bf(hi) << 16); }
__device__ __forceinline__ float bf2f(unsigned b) { return __builtin_bit_cast(float, b << 16); }
__device__ __forceinline__ unsigned cvt_pk_bf16(float lo, float hi) { unsigned r; asm volatile("v_cvt_pk_bf16_f32 %0, %1, %2" : "=v"(r) : "v"(lo), "v"(hi)); return r; }

#define XB_TMO      128
#define XB_XCNT(j)  (256  + 64 * (j))
#define XB_XSUB(j)  (1280 + 64 * (j))
#define XB_XGEN(j)  (2304 + 64 * (j))
#define XB_TOP      3328
#define XB_TOPGEN   3392
#define XCD_BAR_WORDS 3456
#define XB_SPIN_CAP (1u << 18)
__device__ __forceinline__ unsigned xb_ld(unsigned* p)              { return __hip_atomic_load(p, __ATOMIC_RELAXED, __HIP_MEMORY_SCOPE_AGENT); }
__device__ __forceinline__ unsigned xb_add(unsigned* p, unsigned v) { return __hip_atomic_fetch_add(p, v, __ATOMIC_RELAXED, __HIP_MEMORY_SCOPE_AGENT); }
__device__ __forceinline__ unsigned xb_xcc_id() { return (unsigned)__builtin_amdgcn_s_getreg((3 << 11) | 20) & 0xFu; }
#define XB_SPIN(cond, bar) do { unsigned _sp = 0; while (cond) { __builtin_amdgcn_s_sleep(1); \
    if ((++_sp & 255u) == 0u) { if (xb_ld(&(bar)[XB_TMO])) break; if (_sp > XB_SPIN_CAP) { atomicAdd(&(bar)[XB_TMO], 1u); break; } } } } while (0)
struct XcdBarrier { unsigned* bar; unsigned x; volatile LAS unsigned* st; };
__device__ __forceinline__ XcdBarrier xcd_barrier_post(unsigned* bar, volatile LAS unsigned* st) {
    XcdBarrier b; b.bar = bar; b.x = xb_xcc_id(); b.st = st;
    if (threadIdx.x == 0) (void)xb_add(&bar[XB_XCNT(b.x)], 1u);
    return b;
}
__device__ __forceinline__ void xcd_barrier_complete(unsigned* bar, unsigned x, unsigned& nloc, unsigned& nx) {
    const unsigned G = gridDim.x * gridDim.y * gridDim.z;
    unsigned sum, cnt, mine, sp = 0u;
    for (;;) {
        sum = 0u; cnt = 0u; mine = 0u;
#pragma unroll
        for (unsigned j = 0; j < 16; ++j) { const unsigned c = xb_ld(&bar[XB_XCNT(j)]); sum += c; cnt += (c > 0u) ? 1u : 0u; mine = (j == x) ? c : mine; }
        if (sum == G) break;
        __builtin_amdgcn_s_sleep(1);
        if ((++sp & 255u) == 0u) { if (xb_ld(&bar[XB_TMO])) break; if (sp > XB_SPIN_CAP) { atomicAdd(&bar[XB_TMO], 1u); break; } }
    }
    nloc = mine > 0u ? mine : 1u; nx = cnt > 0u ? cnt : 1u;
}
__device__ __forceinline__ void xcd_barrier(const XcdBarrier& b) {
    asm volatile("s_waitcnt vmcnt(0)" ::: "memory");
    __syncthreads();
    if (threadIdx.x == 0) {
        unsigned* bar = b.bar;
        __builtin_amdgcn_s_waitcnt(0);
        unsigned nloc = b.st[0], nx = b.st[1];
        if (nloc == 0u) { xcd_barrier_complete(bar, b.x, nloc, nx); b.st[0] = nloc; b.st[1] = nx; }
        const unsigned old = xb_add(&bar[XB_XSUB(b.x)], 1u);
        const unsigned gen = old / nloc;
        if (old + 1u == (gen + 1u) * nloc) {
            __builtin_amdgcn_fence(__ATOMIC_RELEASE, "agent");
            asm volatile("s_waitcnt vmcnt(0)" ::: "memory");
            const unsigned og = xb_add(&bar[XB_TOP], 1u);
            const unsigned tg = og / nx;
            if (og + 1u == (tg + 1u) * nx) xb_add(&bar[XB_TOPGEN], 1u);
            else XB_SPIN(xb_ld(&bar[XB_TOPGEN]) == tg, bar);
            __builtin_amdgcn_fence(__ATOMIC_ACQUIRE, "agent");
            xb_add(&bar[XB_XGEN(b.x)], 1u);
            asm volatile("s_waitcnt vmcnt(0)" ::: "memory");
        } else {
            XB_SPIN(xb_ld(&bar[XB_XGEN(b.x)]) == gen, bar);
            __builtin_amdgcn_fence(__ATOMIC_ACQUIRE, "agent");
            asm volatile("s_waitcnt vmcnt(0)" ::: "memory");
        }
    }
    __syncthreads();
}

namespace pg8 {
constexpr int BM = 256, BK = 64, HALF = 128, HTB = HALF * BK * 2, NXCD = 8, WGM = 8, NT = 16, LDA = 1024;
__device__ __forceinline__ int lds_byte(int r, int c) { const int st = (r >> 4) * 2 + (c >> 5), rr = r & 15, cc = c & 31, ob = rr * 64 + cc * 2; return st * 1024 + (ob ^ (((ob >> 9) & 1) << 5)); }
__device__ __forceinline__ void stage_rc(int b, int& R, int& C) { const int st = b / 1024, sb = b % 1024, swz = sb ^ (((sb >> 9) & 1) << 5); R = (st >> 1) * 16 + swz / 64; C = (st & 1) * 32 + (swz % 64) / 2; }
__device__ __forceinline__ int perm32(int rho) { const int n = rho >> 4, i = rho & 15; return 8 * (i >> 2) + 4 * n + (i & 3); }

struct Unit { int pm, pn, aux; };

struct StaticOrder {
    int nM, nN, nwg, G, c;
    __device__ __forceinline__ void init(int M, int N, int G_, int c_) { nM = M / BM; nN = N / BM; nwg = nM * nN; G = G_; c = c_; }
    __device__ __forceinline__ bool next(int i, Unit& u) const {
        const long L = (long)i * G + c; if (L >= nwg) return false;
        int wgid = (int)L; { const int q = nwg / NXCD, r = nwg % NXCD, xcd = wgid % NXCD, off = wgid / NXCD; wgid = (xcd < r ? xcd * (q + 1) : r * (q + 1) + (xcd - r) * q) + off; }
        const int nig = WGM * nN, gid = wgid / nig, fm = gid * WGM, gsz = (nM - fm) < WGM ? (nM - fm) : WGM;
        u.pm = fm + ((wgid % nig) % gsz); u.pn = (wgid % nig) / gsz; u.aux = 0; return true;
    }
};
struct DenseSched : StaticOrder {
    const char* A; const char* B; int ldb;
    static constexpr int KSPLIT = 16;
    __device__ __forceinline__ const char* a_base(const Unit& u) const { return A + (size_t)u.pm * (BM * LDA * 2); }
    __device__ __forceinline__ void b_base(const Unit& u, const char*& b0, const char*& b1) const { b0 = B + (size_t)u.pn * BM * ldb * 2; b1 = b0; }
    __device__ __forceinline__ int row_index(const Unit&, int) const { return 0; }
};
__device__ __forceinline__ void cls_experts(int cls, int& ea, int& eb) { const int g = cls / 6, p = cls - g * 6; const int lo = (p >= 5) ? 2 : (p >= 3 ? 1 : 0); const int hi = (p < 3) ? p + 1 : (p < 5 ? p - 1 : 3); ea = g * 4 + lo; eb = g * 4 + hi; }
template <int SHIFT, int KSPLIT_, int LDB_>
struct MoeSched {
    static constexpr int KSPLIT = KSPLIT_;
    int nunits, G, c; unsigned long long packed;
    const char* A; const char* W; const int* rowtok;
    __device__ __forceinline__ void init(const int* tiles, int G_, int c_) {
        G = G_; c = c_; const int nmt = __builtin_amdgcn_readfirstlane(tiles[0]); nunits = nmt << SHIFT; packed = 0ull;
#pragma unroll
        for (int i = 0; i < 8; ++i) { const int L = i * G + c; if (L < nunits) packed |= (unsigned long long)(unsigned)__builtin_amdgcn_readfirstlane(tiles[1 + (L >> SHIFT)]) << (5 * i); }
    }
    __device__ __forceinline__ bool next(int i, Unit& u) const {
        const int L = i * G + c; if (L >= nunits) return false;
        u.pm = L >> SHIFT; u.pn = L & ((1 << SHIFT) - 1); u.aux = (int)((packed >> (5 * i)) & 31ull); return true;
    }
    __device__ __forceinline__ const char* a_base(const Unit& u) const { return (SHIFT == 3) ? A : A + (size_t)u.pm * (BM * LDA * 2); }
    __device__ __forceinline__ void b_base(const Unit& u, const char*& b0, const char*& b1) const {
        int ea, eb; cls_experts(u.aux, ea, eb);
        if (SHIFT == 3) { const int e = (u.pn < 4) ? ea : eb; b0 = W + ((size_t)e * 1024 + (size_t)(u.pn & 3) * 256) * LDB_ * 2; b1 = b0; }
        else { b0 = W + ((size_t)ea * 1024 + (size_t)u.pn * 256) * LDB_ * 2; b1 = W + ((size_t)eb * 1024 + (size_t)u.pn * 256) * LDB_ * 2; }
    }
    __device__ __forceinline__ int row_index(const Unit& u, int r) const { const int t = rowtok[(size_t)(u.pm * 256 + r) * 4]; return t < 0 ? 0 : t; }
};

struct EpiBf16 {
    static constexpr bool PERM = true;
    bf16* O; int ldc;
    __device__ __forceinline__ void operator()(const f32x4 (&acc)[2][2][4][2], const Unit& u, int wr, int wc, int fr, int fq) const {
        const int row0 = u.pm * BM + wr * 64 + fr, col0 = u.pn * BM + wc * 32 + 8 * fq;
#pragma unroll
        for (int ai = 0; ai < 2; ++ai)
#pragma unroll
            for (int m = 0; m < 4; ++m) { bf16* rowp = O + (size_t)(row0 + ai * HALF + m * 16) * ldc + col0;
#pragma unroll
                for (int bj = 0; bj < 2; ++bj) { const f32x4 v0 = acc[ai][bj][m][0], v1 = acc[ai][bj][m][1];
                    v4u w; w.x = cvt_pk_bf16(v0[0], v0[1]); w.y = cvt_pk_bf16(v0[2], v0[3]); w.z = cvt_pk_bf16(v1[0], v1[1]); w.w = cvt_pk_bf16(v1[2], v1[3]);
                    *(v4u*)(rowp + bj * HALF) = w; } }
    }
};
struct EpiRes {
    static constexpr bool PERM = false;
    float* out;
    __device__ __forceinline__ void operator()(const f32x4 (&acc)[2][2][4][2], const Unit& u, int wr, int wc, int fr, int fq) const {
        const int row0 = u.pm * BM + wr * 64 + fr, col0 = u.pn * BM + wc * 32 + 4 * fq;
#pragma unroll
        for (int ai = 0; ai < 2; ++ai)
#pragma unroll
            for (int m = 0; m < 4; ++m) { float* rowp = out + (size_t)(row0 + ai * HALF + m * 16) * D + col0;
#pragma unroll
                for (int bj = 0; bj < 2; ++bj)
#pragma unroll
                    for (int n = 0; n < 2; ++n) { float* p = rowp + bj * HALF + n * 16; const f32x4 b = *(const f32x4*)p; *(f32x4*)p = b * ALPHA + acc[ai][bj][m][n]; }
                asm volatile("" ::: "memory"); }
    }
};
__device__ __forceinline__ float silu_mul(float a, float b) { const float e = __builtin_amdgcn_exp2f(a * -1.4426950408889634f); return a * __builtin_amdgcn_rcpf(1.0f + e) * b; }
struct EpiSwiglu {
    static constexpr bool PERM = false;
    bf16* hid; const f32x4* rowinfo;
    __device__ __forceinline__ void operator()(const f32x4 (&acc)[2][2][4][2], const Unit& u, int wr, int wc, int fr, int fq) const {
        const int which = u.pn >> 2; const int col0 = which * 512 + (u.pn & 3) * 128 + wc * 16 + 4 * fq;
#pragma unroll
        for (int ai = 0; ai < 2; ++ai)
#pragma unroll
            for (int m = 0; m < 4; ++m) { const int r = u.pm * BM + ai * HALF + wr * 64 + m * 16 + fr; const f32x4 ri = rowinfo[r];
                const float g = (__builtin_bit_cast(int, ri[0]) < 0) ? 0.f : (which ? ri[2] : ri[1]);
                bf16* rowp = hid + (size_t)r * 1024 + col0;
#pragma unroll
                for (int bj = 0; bj < 2; ++bj) { const f32x4 a = acc[ai][bj][m][0], b = acc[ai][bj][m][1];
                    v2u w; w.x = cvt_pk_bf16(g * silu_mul(a[0], b[0]), g * silu_mul(a[1], b[1])); w.y = cvt_pk_bf16(g * silu_mul(a[2], b[2]), g * silu_mul(a[3], b[3]));
                    *(v2u*)(rowp + bj * 64) = w; } }
    }
};
struct EpiMoeOut {
    static constexpr bool PERM = false;
    float* out; const f32x4* rowinfo;
    __device__ __forceinline__ void operator()(const f32x4 (&acc)[2][2][4][2], const Unit& u, int wr, int wc, int fr, int fq) const {
        const int col0 = u.pn * BM + wc * 32 + 4 * fq;
#pragma unroll
        for (int ai = 0; ai < 2; ++ai)
#pragma unroll
            for (int m = 0; m < 4; ++m) { const int r = u.pm * BM + ai * HALF + wr * 64 + m * 16 + fr; const int tok = __builtin_bit_cast(int, rowinfo[r][0]);
                if (tok >= 0) { float* rowp = out + (size_t)tok * D + col0;
#pragma unroll
                    for (int bj = 0; bj < 2; ++bj)
#pragma unroll
                        for (int n = 0; n < 2; ++n) { float* p = rowp + bj * HALF + n * 16; const f32x4 b = *(const f32x4*)p; *(f32x4*)p = b * ALPHA + acc[ai][bj][m][n]; } }
                asm volatile("" ::: "memory"); }
    }
};

template <class Epi, class Sched, bool GATHER, int LDB, bool ALIGN_EPI>
__device__ __forceinline__ void gemm_phase(LAS unsigned char* lds, LAS int* gtab, const Sched& S, const Epi& E, const int tid) {
    const int wid = __builtin_amdgcn_readfirstlane(tid >> 6), lane = tid & 63, wr = wid >> 2, wc = wid & 3, fr = lane & 15, fq = lane >> 4;
    constexpr int KSPLIT = Sched::KSPLIT;
    Unit cur, nxt; int ui = 0;
    if (!S.next(0, cur)) return;
    if constexpr (GATHER) {
        Unit u;
        for (int i = 0; S.next(i, u); ++i) if (tid < 256) gtab[i * 256 + tid] = S.row_index(u, tid);
        LDS_WAIT(); __syncthreads();
    }
    unsigned voffA[2][2], voffB[2];
#pragma unroll
    for (int i = 0; i < 2; ++i) { int R, C; stage_rc(tid * 16 + i * 8192, R, C); const int Rb = Epi::PERM ? ((R & ~31) + perm32(R & 31)) : R;
        voffB[i] = (unsigned)(Rb * LDB + C) * 2u;
#pragma unroll
        for (int h = 0; h < 2; ++h) { const int row = GATHER ? gtab[h * 128 + R] : (h * 128 + R); voffA[h][i] = (unsigned)(row * LDA + C) * 2u; } }
    constexpr size_t kstep = (size_t)(BK * 2);
    constexpr size_t hstepB = (size_t)HALF * LDB * 2;
    const unsigned ldsw = (unsigned)wid * 1024u;
    const int aoff = lds_byte(wr * 64 + fr, fq * 8), boff = lds_byte(wc * 32 + fr, fq * 8);
#define PG8_SA(b, h) (((b) * 2 + (h)) * HTB)
#define PG8_SB(b, h) ((4 + (b) * 2 + (h)) * HTB)
#define PG8_STAGE(bufoff, gbase, voff) do { _Pragma("unroll") for (int _i = 0; _i < 2; ++_i) \
        __builtin_amdgcn_global_load_lds((const unsigned*)((const char*)(gbase) + (voff)[_i]), (LAS unsigned*)(lds + (bufoff) + ldsw + _i * 8192), 16, 0, 0); } while (0)
#define PG8_LDA(dst, b, h) do { _Pragma("unroll") for (int m = 0; m < 4; ++m) _Pragma("unroll") for (int k = 0; k < 2; ++k) dst[m][k] = *(const LAS bf16x8*)(lds + PG8_SA(b, h) + aoff + m * 2048 + k * 1024); } while (0)
#define PG8_LDB(dst, b, h) do { _Pragma("unroll") for (int n = 0; n < 2; ++n) _Pragma("unroll") for (int k = 0; k < 2; ++k) dst[n][k] = *(const LAS bf16x8*)(lds + PG8_SB(b, h) + boff + n * 2048 + k * 1024); } while (0)
#define PG8_MMA(ai, bj, At, Bt) do { __builtin_amdgcn_s_setprio(1); _Pragma("unroll") for (int m = 0; m < 4; ++m) _Pragma("unroll") for (int n = 0; n < 2; ++n) _Pragma("unroll") for (int k = 0; k < 2; ++k) \
        acc[ai][bj][m][n] = __builtin_amdgcn_mfma_f32_16x16x32_bf16(Bt[n][k], At[m][k], acc[ai][bj][m][n], 0, 0, 0); __builtin_amdgcn_s_setprio(0); } while (0)
#define PG8_WAIT_V(n) asm volatile("s_waitcnt vmcnt(" #n ")" ::: "memory")
#define PG8_WAIT_L(n) asm volatile("s_waitcnt lgkmcnt(" #n ")" ::: "memory")
#define PG8_BAR __builtin_amdgcn_s_barrier()
#define PG8_SCHED __builtin_amdgcn_sched_barrier(0)
#define PG8_BSEL(b0, b1, kt) (((kt) < KSPLIT) ? (b0) + (size_t)(kt) * kstep : (b1) + (size_t)((kt) - KSPLIT) * kstep)
    f32x4 acc[2][2][4][2];
#pragma unroll
    for (int a = 0; a < 2; ++a)
#pragma unroll
        for (int b = 0; b < 2; ++b)
#pragma unroll
            for (int m = 0; m < 4; ++m)
#pragma unroll
                for (int n = 0; n < 2; ++n) acc[a][b][m][n] = (f32x4){0.f, 0.f, 0.f, 0.f};
    bf16x8 At[4][2], B0[2][2], B1[2][2];
    const char* cA = S.a_base(cur); const char* cB0; const char* cB1; S.b_base(cur, cB0, cB1);
    PG8_STAGE(PG8_SB(0, 0), cB0, voffB); PG8_STAGE(PG8_SB(0, 1), cB0 + hstepB, voffB); PG8_STAGE(PG8_SA(0, 0), cA, voffA[0]); PG8_STAGE(PG8_SA(0, 1), cA, voffA[1]);
    if (wr == 1) PG8_BAR;
    PG8_WAIT_V(2); PG8_BAR;
    PG8_STAGE(PG8_SB(1, 0), cB0 + kstep, voffB); PG8_STAGE(PG8_SA(1, 0), cA + kstep, voffA[0]); PG8_STAGE(PG8_SB(1, 1), cB0 + hstepB + kstep, voffB);
    PG8_WAIT_V(6); PG8_BAR;
    for (;;) {
        const bool has_next = S.next(ui + 1, nxt);
        const char* nA = cA; const char* nB0 = cB0; const char* nB1 = cB1;
        if (has_next) { nA = S.a_base(nxt); S.b_base(nxt, nB0, nB1); }
        for (int t = 0; t < NT; t += 2) {
            const bool last = (t == NT - 2);
            const char* a1 = cA + (size_t)(t + 1) * kstep;
            const char* a2 = last ? nA : cA + (size_t)(t + 2) * kstep; const char* a3 = a2 + kstep;
            const char* b2 = last ? nB0 : PG8_BSEL(cB0, cB1, t + 2); const char* b3 = last ? nB0 + kstep : PG8_BSEL(cB0, cB1, t + 3);
            PG8_LDB(B0, 0, 0); PG8_LDB(B1, 0, 1); PG8_SCHED; PG8_LDA(At, 0, 0); PG8_STAGE(PG8_SA(1, 1), a1, voffA[1]);
            PG8_WAIT_V(8); PG8_WAIT_L(0); PG8_BAR; PG8_MMA(0, 0, At, B0); PG8_MMA(0, 1, At, B1); PG8_BAR; PG8_SCHED;
            if constexpr (GATHER) { if (last && has_next) {
#pragma unroll
                for (int i = 0; i < 2; ++i) { int R, C; stage_rc(tid * 16 + i * 8192, R, C);
#pragma unroll
                    for (int h = 0; h < 2; ++h) voffA[h][i] = (unsigned)(gtab[(ui + 1) * 256 + h * 128 + R] * LDA + C) * 2u; } } }
            PG8_LDA(At, 0, 1); PG8_STAGE(PG8_SB(0, 0), b2, voffB); PG8_STAGE(PG8_SB(0, 1), b2 + hstepB, voffB); PG8_STAGE(PG8_SA(0, 0), a2, voffA[0]);
            PG8_WAIT_V(8); PG8_WAIT_L(0); PG8_BAR; PG8_MMA(1, 0, At, B0); PG8_MMA(1, 1, At, B1); PG8_BAR; PG8_SCHED;
            PG8_LDB(B0, 1, 0); PG8_LDB(B1, 1, 1); PG8_SCHED; PG8_LDA(At, 1, 0); PG8_STAGE(PG8_SA(0, 1), a2, voffA[1]);
            PG8_WAIT_V(8); PG8_WAIT_L(0); PG8_BAR; PG8_MMA(0, 0, At, B0); PG8_MMA(0, 1, At, B1); PG8_BAR; PG8_SCHED;
            PG8_LDA(At, 1, 1); PG8_STAGE(PG8_SB(1, 0), b3, voffB); PG8_STAGE(PG8_SB(1, 1), b3 + hstepB, voffB); PG8_STAGE(PG8_SA(1, 0), a3, voffA[0]);
            PG8_WAIT_V(8); PG8_WAIT_L(0); PG8_BAR; PG8_MMA(1, 0, At, B0); PG8_MMA(1, 1, At, B1); PG8_BAR; PG8_SCHED;
        }
        if constexpr (ALIGN_EPI) { if (wr == 0) PG8_BAR; }
        E(acc, cur, wr, wc, fr, fq);
        if (!has_next) break;
#pragma unroll
        for (int a = 0; a < 2; ++a)
#pragma unroll
            for (int b = 0; b < 2; ++b)
#pragma unroll
                for (int m = 0; m < 4; ++m)
#pragma unroll
                    for (int n = 0; n < 2; ++n) acc[a][b][m][n] = (f32x4){0.f, 0.f, 0.f, 0.f};
        cur = nxt; cA = nA; cB0 = nB0; cB1 = nB1; ++ui;
        if constexpr (ALIGN_EPI) { if (wr == 1) PG8_BAR; }
    }
    PG8_WAIT_V(0);
    if constexpr (!ALIGN_EPI) { if (wr == 0) PG8_BAR; }
    PG8_BAR;
#undef PG8_SA
#undef PG8_SB
#undef PG8_STAGE
#undef PG8_LDA
#undef PG8_LDB
#undef PG8_MMA
#undef PG8_WAIT_V
#undef PG8_WAIT_L
#undef PG8_BAR
#undef PG8_SCHED
#undef PG8_BSEL
}
}

struct Args { const float* in[18]; float* out; unsigned char* ws; int ph_lo, ph_hi; };
struct Frame {
    LAS unsigned char* lds; volatile LAS unsigned* MISC; unsigned* ctl;
    int tid, lane, wave, vcu, G;
    unsigned char* ws; float* out;
};
__device__ __forceinline__ float wave_sum(float v) {
#pragma unroll
    for (int o = 1; o < 64; o <<= 1) v += __shfl_xor(v, o);
    return v;
}

__device__ __forceinline__ void tr_item(const float* W, int ldw, int nblk, bf16* WT, int ldt, int map, LAS float* scr, int item, int lane) {
    const int kb = item / nblk, nb = item % nblk, k0 = 64 * kb, n0 = 32 * nb;
#pragma unroll 8
    for (int i = 0; i < 32; ++i) { const int kk = 2 * i + (lane >> 5); scr[kk * 33 + (lane & 31)] = W[(size_t)(k0 + kk) * ldw + n0 + (lane & 31)]; }
    LDS_WAIT(); asm volatile("" ::: "memory");
    const int c = lane & 7;
#pragma unroll
    for (int j = 0; j < 4; ++j) { const int n = (lane >> 3) + 8 * j; const LAS float* s = scr + (8 * c) * 33 + n;
        v4u o; o.x = pk2(s[0 * 33], s[1 * 33]); o.y = pk2(s[2 * 33], s[3 * 33]); o.z = pk2(s[4 * 33], s[5 * 33]); o.w = pk2(s[6 * 33], s[7 * 33]);
        const int nr = n0 + n; const int row = map ? (((nr >> 4) << 5) + (nr & 15) + (map == 2 ? 16 : 0)) : nr;
        *(v4u*)(WT + (size_t)row * ldt + k0 + 8 * c) = o; }
    LDS_WAIT(); asm volatile("" ::: "memory");
}
__device__ __forceinline__ void ln_row(const float* src, float* dstf, bf16* dstb, const float* g, const float* b, int lane, f32x4 (&v)[4]) {
    const f32x4* xr = (const f32x4*)src + lane; float s = 0.f;
#pragma unroll
    for (int j = 0; j < 4; ++j) { v[j] = xr[64 * j]; s += (v[j].x + v[j].y) + (v[j].z + v[j].w); }
    const float mean = wave_sum(s) * (1.f / D); float s2 = 0.f;
#pragma unroll
    for (int j = 0; j < 4; ++j) { v[j] = v[j] - mean; s2 += (v[j].x * v[j].x + v[j].y * v[j].y) + (v[j].z * v[j].z + v[j].w * v[j].w); }
    const float rstd = 1.f / sqrtf(wave_sum(s2) * (1.f / D) + LN_EPS);
    f32x4* of = (f32x4*)dstf + lane; v2u* ob = (v2u*)dstb + lane;
#pragma unroll
    for (int j = 0; j < 4; ++j) { const f32x4 gg = ((const f32x4*)g)[lane + 64 * j], bb = ((const f32x4*)b)[lane + 64 * j]; v[j] = v[j] * rstd * gg + bb; of[64 * j] = v[j];
        if (dstb) { v2u w; w.x = pk2(v[j].x, v[j].y); w.y = pk2(v[j].z, v[j].w); ob[64 * j] = w; } }
}

__device__ __forceinline__ void p0_prologue(Frame& F, const Args& a) {
    const float* x = a.in[0]; const float* ln_in_g = a.in[1]; const float* ln_in_b = a.in[2]; const float* w_in = a.in[3]; const float* pool_w = a.in[4]; const float* pool_scale = a.in[5];
    const float* w_out = a.in[8]; const float* exp_w1 = a.in[13]; const float* exp_w3 = a.in[14]; const float* exp_w2 = a.in[15];
    bf16* Win_t = (bf16*)(F.ws + WS_WIN); bf16* Wcat_t = (bf16*)(F.ws + WS_WCAT); bf16* W13_t = (bf16*)(F.ws + WS_W13); bf16* W2_t = (bf16*)(F.ws + WS_W2);
    {
        LAS float* Ps = (LAS float*)F.lds;
        LAS float* Bs = (LAS float*)(F.lds + 128 * 132 * 4);
        for (int it = F.vcu; it < NL * 4 * 16; it += F.G) {
            const int l = it >> 6, g = (it >> 4) & 3, nb = it & 15;
            const float* pw = pool_w + ((size_t)(l * 4 + g) * 128) * 128;
            for (int i = F.tid; i < 128 * 128; i += NTHREADS) Ps[(i >> 7) * 132 + (i & 127)] = pw[i];
            for (int i = F.tid; i < 128 * 64; i += NTHREADS) { const int d = i >> 6, n = i & 63; Bs[i] = w_out[((size_t)l * 1024 + g * 128 + d) * 1024 + nb * 64 + n] * pool_scale[l * 512 + g * 128 + d]; }
            LDS_WAIT(); __syncthreads();
            const int n = F.tid & 63, c0 = (F.tid >> 6) * 16;
            float acc[16];
#pragma unroll
            for (int cc = 0; cc < 16; ++cc) acc[cc] = 0.f;
            for (int d4 = 0; d4 < 32; ++d4) {
                const float b0 = Bs[(d4 * 4 + 0) * 64 + n], b1 = Bs[(d4 * 4 + 1) * 64 + n], b2 = Bs[(d4 * 4 + 2) * 64 + n], b3 = Bs[(d4 * 4 + 3) * 64 + n];
#pragma unroll
                for (int cc = 0; cc < 16; ++cc) { const f32x4 a4 = *(const LAS f32x4*)(Ps + (c0 + cc) * 132 + d4 * 4); acc[cc] += a4.x * b0 + a4.y * b1 + a4.z * b2 + a4.w * b3; }
            }
            bf16* dst = Wcat_t + ((size_t)l * 1024 + nb * 64 + n) * 1024 + g * 128 + c0;
            v4u o0, o1; o0.x = pk2(acc[0], acc[1]); o0.y = pk2(acc[2], acc[3]); o0.z = pk2(acc[4], acc[5]); o0.w = pk2(acc[6], acc[7]);
            o1.x = pk2(acc[8], acc[9]); o1.y = pk2(acc[10], acc[11]); o1.z = pk2(acc[12], acc[13]); o1.w = pk2(acc[14], acc[15]);
            *(v4u*)dst = o0; *(v4u*)(dst + 8) = o1;
            __syncthreads();
        }
    }
    {
        LAS float* scr = (LAS float*)(F.lds + F.wave * 16384);
        const int gw = F.vcu * NWAVES + F.wave, NGW = F.G * NWAVES;
        constexpr int PER_L = 1024 + 256 + NE * 768;
        for (int it = gw; it < NL * PER_L; it += NGW) {
            const int l = it / PER_L; int r = it - l * PER_L;
            if (r < 1024) { tr_item(w_in + (size_t)l * D * DP, DP, DP / 32, Win_t + (size_t)l * DP * D, D, 0, scr, r, F.lane); continue; } r -= 1024;
            if (r < 256) { tr_item(w_out + ((size_t)l * 1024 + 512) * 1024, 1024, 32, Wcat_t + (size_t)l * 1024 * 1024 + 512, 1024, 0, scr, r, F.lane); continue; } r -= 256;
            const int e = r / 768, q = r - e * 768, kind = q >> 8, item = q & 255; const size_t le = (size_t)l * NE + e;
            if (kind == 0) tr_item(exp_w1 + le * D * FF, FF, FF / 32, W13_t + le * 1024 * 1024, 1024, 1, scr, item, F.lane);
            else if (kind == 1) tr_item(exp_w3 + le * D * FF, FF, FF / 32, W13_t + le * 1024 * 1024, 1024, 2, scr, item, F.lane);
            else tr_item(exp_w2 + le * FF * D, D, D / 32, W2_t + le * 1024 * 512, 512, 0, scr, item, F.lane);
        }
    }
    {
        bf16* hb = (bf16*)(F.ws + WS_HB);
        const int gw = F.vcu * NWAVES + F.wave, NGW = F.G * NWAVES;
        for (int m = gw; m < T; m += NGW) { f32x4 v[4]; ln_row(x + (size_t)m * D, F.out + (size_t)m * D, hb + (size_t)m * D, ln_in_g, ln_in_b, F.lane, v); }
    }
}

__device__ __forceinline__ void phase_mixin(Frame& F, const Args& a, int l) {
    const bf16* proj = (const bf16*)(F.ws + WS_PROJ); bf16* mix = (bf16*)(F.ws + WS_MIX);
    const float* conv_w = a.in[6] + (size_t)l * 3 * 512; const float* conv_b = a.in[7] + (size_t)l * 512;
    const int oct = F.tid & 127, sub = F.tid >> 7;
    for (int chunk = F.vcu; chunk < T / 64; chunk += F.G) {
        const int t0 = chunk * 64 + sub * 16, pos0 = t0 & (SEQ - 1);
        if (oct < 64) {
            const int g = oct >> 4, win = 2 << g;
            float S[8];
#pragma unroll
            for (int k = 0; k < 8; ++k) S[k] = 0.f;
            for (int i = 1; i < win; ++i) if (pos0 - i >= 0) { const v4u w = *(const v4u*)(proj + (size_t)(t0 - i) * DP + oct * 8);
                S[0] += bf2f(w.x & 0xffffu); S[1] += bf2f(w.x >> 16); S[2] += bf2f(w.y & 0xffffu); S[3] += bf2f(w.y >> 16); S[4] += bf2f(w.z & 0xffffu); S[5] += bf2f(w.z >> 16); S[6] += bf2f(w.w & 0xffffu); S[7] += bf2f(w.w >> 16); }
            for (int i = 0; i < 16; ++i) {
                const int t = t0 + i, pos = pos0 + i;
                const v4u w = *(const v4u*)(proj + (size_t)t * DP + oct * 8);
                float v[8] = {bf2f(w.x & 0xffffu), bf2f(w.x >> 16), bf2f(w.y & 0xffffu), bf2f(w.y >> 16), bf2f(w.z & 0xffffu), bf2f(w.z >> 16), bf2f(w.w & 0xffffu), bf2f(w.w >> 16)};
                const float inv = 1.0f / (float)((pos + 1 < win) ? pos + 1 : win);
                float o[8];
#pragma unroll
                for (int k = 0; k < 8; ++k) { S[k] += v[k]; o[k] = S[k] * inv - v[k]; }
                v4u ow; ow.x = pk2(o[0], o[1]); ow.y = pk2(o[2], o[3]); ow.z = pk2(o[4], o[5]); ow.w = pk2(o[6], o[7]);
                *(v4u*)(mix + (size_t)t * D + oct * 8) = ow;
                if (pos - win + 1 >= 0) { const v4u q = *(const v4u*)(proj + (size_t)(t - win + 1) * DP + oct * 8);
                    S[0] -= bf2f(q.x & 0xffffu); S[1] -= bf2f(q.x >> 16); S[2] -= bf2f(q.y & 0xffffu); S[3] -= bf2f(q.y >> 16); S[4] -= bf2f(q.z & 0xffffu); S[5] -= bf2f(q.z >> 16); S[6] -= bf2f(q.w & 0xffffu); S[7] -= bf2f(q.w >> 16); }
            }
        } else {
            const int c0 = (oct - 64) * 8;
            float w0[8], w1[8], w2[8], cb[8], z1[8], z2[8];
#pragma unroll
            for (int k = 0; k < 8; ++k) { w0[k] = conv_w[c0 + k]; w1[k] = conv_w[512 + c0 + k]; w2[k] = conv_w[1024 + c0 + k]; cb[k] = conv_b[c0 + k]; z1[k] = 0.f; z2[k] = 0.f; }
#pragma unroll
            for (int j = 2; j >= 1; --j) if (pos0 - j >= 0) { const bf16* pr = proj + (size_t)(t0 - j) * DP + c0; const v4u gc = *(const v4u*)(pr + 1024), uu = *(const v4u*)(pr + 1536);
                float z[8] = {bf2f(gc.x & 0xffffu) * bf2f(uu.x & 0xffffu), bf2f(gc.x >> 16) * bf2f(uu.x >> 16), bf2f(gc.y & 0xffffu) * bf2f(uu.y & 0xffffu), bf2f(gc.y >> 16) * bf2f(uu.y >> 16),
                              bf2f(gc.z & 0xffffu) * bf2f(uu.z & 0xffffu), bf2f(gc.z >> 16) * bf2f(uu.z >> 16), bf2f(gc.w & 0xffffu) * bf2f(uu.w & 0xffffu), bf2f(gc.w >> 16) * bf2f(uu.w >> 16)};
#pragma unroll
                for (int k = 0; k < 8; ++k) { if (j == 2) z2[k] = z[k]; else z1[k] = z[k]; } }
            for (int i = 0; i < 16; ++i) {
                const int t = t0 + i; const bf16* pr = proj + (size_t)t * DP + c0;
                const v4u gb = *(const v4u*)(pr + 512), gc = *(const v4u*)(pr + 1024), uu = *(const v4u*)(pr + 1536);
                float z[8] = {bf2f(gc.x & 0xffffu) * bf2f(uu.x & 0xffffu), bf2f(gc.x >> 16) * bf2f(uu.x >> 16), bf2f(gc.y & 0xffffu) * bf2f(uu.y & 0xffffu), bf2f(gc.y >> 16) * bf2f(uu.y >> 16),
                              bf2f(gc.z & 0xffffu) * bf2f(uu.z & 0xffffu), bf2f(gc.z >> 16) * bf2f(uu.z >> 16), bf2f(gc.w & 0xffffu) * bf2f(uu.w & 0xffffu), bf2f(gc.w >> 16) * bf2f(uu.w >> 16)};
                float gbf[8] = {bf2f(gb.x & 0xffffu), bf2f(gb.x >> 16), bf2f(gb.y & 0xffffu), bf2f(gb.y >> 16), bf2f(gb.z & 0xffffu), bf2f(gb.z >> 16), bf2f(gb.w & 0xffffu), bf2f(gb.w >> 16)};
                float o[8];
#pragma unroll
                for (int k = 0; k < 8; ++k) { o[k] = gbf[k] * (w0[k] * z2[k] + w1[k] * z1[k] + w2[k] * z[k] + cb[k]); z2[k] = z1[k]; z1[k] = z[k]; }
                v4u ow; ow.x = pk2(o[0], o[1]); ow.y = pk2(o[2], o[3]); ow.z = pk2(o[4], o[5]); ow.w = pk2(o[6], o[7]);
                *(v4u*)(mix + (size_t)t * D + 512 + c0) = ow;
            }
        }
    }
}

template <bool ROUTE>
__device__ __forceinline__ void phase_ln(Frame& F, const Args& a, int l, const float* g, const float* b, bool write_hb) {
    bf16* hb = (bf16*)(F.ws + WS_HB);
    LAS f32x4* wrs = (LAS f32x4*)F.lds;
    LAS int* lhist = (LAS int*)(F.lds + 65536);
    if (ROUTE) {
        const float* w_router = a.in[11];
        for (int idx = F.tid; idx < 1024 * 4; idx += NTHREADS) { const int c = idx >> 2, q = idx & 3, j = c >> 8, ln = (c & 255) >> 2, i = c & 3;
            wrs[((j * 4 + i) * 4 + q) * 64 + ln] = *(const f32x4*)(w_router + (size_t)c * 16 + 4 * q); }
        if (F.tid < 32) lhist[F.tid] = 0;
        LDS_WAIT(); __syncthreads();
    }
    const float* rbias = a.in[12];
    f32x4* tokinfo = (f32x4*)(F.ws + WS_TOKINFO);
    for (int chunk = F.vcu; chunk < T / 64; chunk += F.G) {
        for (int rr = 0; rr < 8; ++rr) {
            const int row = chunk * 64 + F.wave * 8 + rr;
            f32x4 v[4];
            ln_row(F.out + (size_t)row * D, F.out + (size_t)row * D, write_hb ? hb + (size_t)row * D : nullptr, g, b, F.lane, v);
            if (ROUTE) {
                float lg[16];
#pragma unroll
                for (int e = 0; e < 16; ++e) lg[e] = 0.f;
#pragma unroll
                for (int j = 0; j < 4; ++j)
#pragma unroll
                    for (int i = 0; i < 4; ++i) { const float hv = v[j][i];
#pragma unroll
                        for (int q = 0; q < 4; ++q) { const f32x4 w = wrs[((j * 4 + i) * 4 + q) * 64 + F.lane]; lg[4 * q + 0] += hv * w.x; lg[4 * q + 1] += hv * w.y; lg[4 * q + 2] += hv * w.z; lg[4 * q + 3] += hv * w.w; } }
                float r8[8], r4[4], r2[2], r1;
                { const bool up = (F.lane & 32) != 0;
#pragma unroll
                  for (int k = 0; k < 8; ++k) { const float send = up ? lg[k] : lg[k + 8], keep = up ? lg[k + 8] : lg[k]; r8[k] = keep + __shfl_xor(send, 32); } }
                { const bool up = (F.lane & 16) != 0;
#pragma unroll
                  for (int k = 0; k < 4; ++k) { const float send = up ? r8[k] : r8[k + 4], keep = up ? r8[k + 4] : r8[k]; r4[k] = keep + __shfl_xor(send, 16); } }
                { const bool up = (F.lane & 8) != 0;
#pragma unroll
                  for (int k = 0; k < 2; ++k) { const float send = up ? r4[k] : r4[k + 2], keep = up ? r4[k + 2] : r4[k]; r2[k] = keep + __shfl_xor(send, 8); } }
                { const bool up = (F.lane & 4) != 0; const float send = up ? r2[0] : r2[1], keep = up ? r2[1] : r2[0]; r1 = keep + __shfl_xor(send, 4); }
                r1 += __shfl_xor(r1, 2); r1 += __shfl_xor(r1, 1);
                float lgt[16];
#pragma unroll
                for (int e = 0; e < 16; ++e) lgt[e] = __builtin_bit_cast(float, __builtin_amdgcn_readlane(__builtin_bit_cast(int, r1), e * 4));
                float mx = lgt[0];
#pragma unroll
                for (int e = 1; e < 16; ++e) mx = fmaxf(mx, lgt[e]);
                float p[16], s = 0.f;
#pragma unroll
                for (int e = 0; e < 16; ++e) { p[e] = __expf(lgt[e] - mx); s += p[e]; }
                const float inv = 1.0f / s;
                float sel[16];
#pragma unroll
                for (int e = 0; e < 16; ++e) { p[e] *= inv; sel[e] = p[e] + rbias[e]; }
                float gs[4];
#pragma unroll
                for (int gq = 0; gq < 4; ++gq) { const float a0 = sel[4 * gq], a1 = sel[4 * gq + 1], a2 = sel[4 * gq + 2], a3 = sel[4 * gq + 3];
                    const float h01 = fmaxf(a0, a1), l01 = fminf(a0, a1), h23 = fmaxf(a2, a3), l23 = fminf(a2, a3);
                    gs[gq] = fmaxf(h01, h23) + fmaxf(fminf(h01, h23), fmaxf(l01, l23)); }
                int gi = 0; float gb = gs[0];
#pragma unroll
                for (int gq = 1; gq < 4; ++gq) if (gs[gq] > gb) { gb = gs[gq]; gi = gq; }
                float s4[4], p4[4];
#pragma unroll
                for (int k = 0; k < 4; ++k) { s4[k] = gi == 0 ? sel[k] : (gi == 1 ? sel[4 + k] : (gi == 2 ? sel[8 + k] : sel[12 + k])); p4[k] = gi == 0 ? p[k] : (gi == 1 ? p[4 + k] : (gi == 2 ? p[8 + k] : p[12 + k])); }
                int e0 = 0; float b0 = s4[0];
#pragma unroll
                for (int k = 1; k < 4; ++k) if (s4[k] > b0) { b0 = s4[k]; e0 = k; }
                int e1 = -1; float b1 = -3.0e38f;
#pragma unroll
                for (int k = 0; k < 4; ++k) if (k != e0 && s4[k] > b1) { b1 = s4[k]; e1 = k; }
                const int lo = e0 < e1 ? e0 : e1, hi = e0 < e1 ? e1 : e0;
                const float plo = lo == 0 ? p4[0] : (lo == 1 ? p4[1] : p4[2]);
                const float phi = hi == 1 ? p4[1] : (hi == 2 ? p4[2] : p4[3]);
                const float gsum = 1.0f / (plo + phi);
                const int pidx = lo == 0 ? hi - 1 : (lo == 1 ? hi + 1 : 5);
                const int cls = gi * 6 + pidx;
                if (F.lane == 0) { f32x4 ti; ti[0] = __builtin_bit_cast(float, cls); ti[1] = plo * gsum; ti[2] = phi * gsum; ti[3] = 0.f; tokinfo[row] = ti; __hip_atomic_fetch_add(&lhist[cls], 1, __ATOMIC_RELAXED, __HIP_MEMORY_SCOPE_WORKGROUP); }
            }
        }
    }
    if (ROUTE) {
        LDS_WAIT(); __syncthreads();
        if (F.tid < NCLS && lhist[F.tid] != 0) atomicAdd(F.ctl + CW_HIST + 64 * l + F.tid, (unsigned)lhist[F.tid]);
    }
}

__device__ __forceinline__ void phase_scatter(Frame& F, int l) {
    LAS int* sh = (LAS int*)F.lds;
    const f32x4* tokinfo = (const f32x4*)(F.ws + WS_TOKINFO); f32x4* rowinfo = (f32x4*)(F.ws + WS_ROWINFO);
    int* tiles = (int*)(F.ws + WS_TILES) + l * 128;
    if (F.tid < NCLS) sh[F.tid] = (int)__hip_atomic_load(F.ctl + CW_HIST + 64 * l + F.tid, RLX_AGENT);
    LDS_WAIT(); __syncthreads();
    if (F.tid == 0) { int off = 0; for (int c = 0; c < NCLS; ++c) { sh[32 + c] = off; off += (sh[c] + 255) >> 8; } sh[128] = off; }
    LDS_WAIT(); __syncthreads();
    if (blockIdx.x == 0) {
        if (F.tid == 0) tiles[0] = sh[128];
        if (F.tid < NCLS) { const int nt = (sh[F.tid] + 255) >> 8; for (int j = 0; j < nt; ++j) tiles[1 + sh[32 + F.tid] + j] = F.tid; }
    }
    for (int c = blockIdx.x; c < NCLS; c += F.G) { const int n = sh[c], base = sh[32 + c] * 256, end = base + (((n + 255) >> 8) << 8);
        for (int p = base + n + F.tid; p < end; p += NTHREADS) { f32x4 ri; ri[0] = __builtin_bit_cast(float, -1); ri[1] = 0.f; ri[2] = 0.f; ri[3] = __builtin_bit_cast(float, c); rowinfo[p] = ri; } }
    for (int chunk = F.vcu; chunk < T / 64; chunk += F.G) {
        if (F.tid < NCLS) sh[64 + F.tid] = 0;
        LDS_WAIT(); __syncthreads();
        f32x4 ti; int cls = 0, rank = 0;
        if (F.tid < 64) { ti = tokinfo[chunk * 64 + F.tid]; cls = __builtin_bit_cast(int, ti[0]); rank = __hip_atomic_fetch_add(&sh[64 + cls], 1, __ATOMIC_RELAXED, __HIP_MEMORY_SCOPE_WORKGROUP); }
        LDS_WAIT(); __syncthreads();
        if (F.tid < NCLS) { const int n = sh[64 + F.tid]; sh[96 + F.tid] = n ? (int)atomicAdd(F.ctl + CW_CURS + 64 * l + F.tid, (unsigned)n) : 0; }
        LDS_WAIT(); __syncthreads();
        if (F.tid < 64) { const int pos = sh[32 + cls] * 256 + sh[96 + cls] + rank; f32x4 ri; ri[0] = __builtin_bit_cast(float, chunk * 64 + F.tid); ri[1] = ti[1]; ri[2] = ti[2]; ri[3] = ti[0]; rowinfo[pos] = ri; }
        __syncthreads();
    }
}

constexpr int NPHASE = 1 + 8 * NL;
__global__ void __launch_bounds__(NTHREADS, 2) mk_fwd(Args args) {
    extern __shared__ __attribute__((aligned(16))) unsigned char lds_raw[];
    Frame F;
    F.lds = (LAS unsigned char*)lds_raw;
    F.MISC = (volatile LAS unsigned*)(F.lds + MISC_OFF);
    F.tid = threadIdx.x; F.lane = F.tid & 63; F.wave = __builtin_amdgcn_readfirstlane(F.tid >> 6);
    F.G = gridDim.x; { const int bx = blockIdx.x; F.vcu = (F.G % 8 == 0) ? (bx % 8) * (F.G / 8) + bx / 8 : bx; }
    F.ws = args.ws; F.out = args.out; F.ctl = (unsigned*)(args.ws + WS_CTL);
    for (int u = F.tid; u < (LDS_BYTES - LDSCTL_OFF) / 4; u += NTHREADS) ((LAS unsigned*)(F.lds + LDSCTL_OFF))[u] = 0u;
    __syncthreads();
    const int lo = args.ph_lo, hi = args.ph_hi;
    XcdBarrier bar; bar.bar = F.ctl + CW_BAR; bar.x = 0; bar.st = nullptr;
    if (hi - lo > 1) bar = xcd_barrier_post(F.ctl + CW_BAR, F.MISC + 8);
    LAS int* gtab = (LAS int*)(F.lds + GTAB_OFF);
    bf16* hb = (bf16*)(F.ws + WS_HB); bf16* proj = (bf16*)(F.ws + WS_PROJ); bf16* mix = (bf16*)(F.ws + WS_MIX); bf16* hid = (bf16*)(F.ws + WS_HID);
    const f32x4* rowinfo = (const f32x4*)(F.ws + WS_ROWINFO);

    for (int ph = lo; ph < hi; ++ph) {
        { int t_ = threadIdx.x; asm volatile("" : "+v"(t_)); F.tid = t_; F.lane = t_ & 63; F.wave = __builtin_amdgcn_readfirstlane(t_ >> 6); }
#ifndef PHMASK
#define PHMASK 0x1ff
#endif
        if (ph == 0) { if (PHMASK & 256) p0_prologue(F, args); }
        else {
            const int l = (ph - 1) >> 3, k = (ph - 1) & 7;
            if (k == 0 && (PHMASK & 1)) {
                pg8::DenseSched S; S.init(T, DP, F.G, (int)blockIdx.x); S.A = (const char*)hb; S.B = (const char*)(F.ws + WS_WIN) + (size_t)l * DP * D * 2; S.ldb = 1024;
                pg8::EpiBf16 E{proj, DP};
                pg8::gemm_phase<pg8::EpiBf16, pg8::DenseSched, false, 1024, true>(F.lds, gtab, S, E, F.tid);
            } else if (k == 1 && (PHMASK & 2)) phase_mixin(F, args, l);
            else if (k == 2 && (PHMASK & 4)) {
                pg8::DenseSched S; S.init(T, D, F.G, (int)blockIdx.x); S.A = (const char*)mix; S.B = (const char*)(F.ws + WS_WCAT) + (size_t)l * D * D * 2; S.ldb = 1024;
                pg8::EpiRes E{F.out};
                pg8::gemm_phase<pg8::EpiRes, pg8::DenseSched, false, 1024, true>(F.lds, gtab, S, E, F.tid);
            } else if (k == 3 && (PHMASK & 8)) phase_ln<true>(F, args, l, args.in[9] + (size_t)l * D, args.in[10] + (size_t)l * D, true);
            else if (k == 4 && (PHMASK & 16)) phase_scatter(F, l);
            else if (k == 5 && (PHMASK & 32)) {
                typedef pg8::MoeSched<3, 16, 1024> Sch; Sch S; S.A = (const char*)hb; S.W = (const char*)(F.ws + WS_W13) + (size_t)l * NE * 1024 * 1024 * 2; S.rowtok = (const int*)(F.ws + WS_ROWINFO);
                S.init((const int*)(F.ws + WS_TILES) + l * 128, F.G, (int)blockIdx.x);
                pg8::EpiSwiglu E{hid, rowinfo};
                pg8::gemm_phase<pg8::EpiSwiglu, Sch, true, 1024, true>(F.lds, gtab, S, E, F.tid);
            } else if (k == 6 && (PHMASK & 64)) {
                typedef pg8::MoeSched<2, 8, 512> Sch; Sch S; S.A = (const char*)hid; S.W = (const char*)(F.ws + WS_W2) + (size_t)l * NE * 1024 * 512 * 2; S.rowtok = (const int*)(F.ws + WS_ROWINFO);
                S.init((const int*)(F.ws + WS_TILES) + l * 128, F.G, (int)blockIdx.x);
                pg8::EpiMoeOut E{F.out, rowinfo};
                pg8::gemm_phase<pg8::EpiMoeOut, Sch, false, 512, true>(F.lds, gtab, S, E, F.tid);
            } else if (k == 7 && (PHMASK & 128)) phase_ln<false>(F, args, l, args.in[16] + (size_t)l * D, args.in[17] + (size_t)l * D, l + 1 < NL);
        }
        if (ph + 1 < hi) xcd_barrier(bar);
    }
}

extern "C" void kernel_launch(void* const* d_in, const int* in_sizes, int n_in, void* d_out, int out_size, void* d_ws, size_t ws_size, hipStream_t stream) {
    static int grid = 0;
    if (grid == 0) {
        if (n_in != 18 || in_sizes[0] != T * D || out_size != T * D || ws_size < WS_END) { fprintf(stderr, "kernel_launch: unexpected shapes (n_in %d, in0 %d, out %d, ws %zu)\n", n_in, n_in > 0 ? in_sizes[0] : -1, out_size, ws_size); grid = -1; return; }
        int dev = 0, cus = 0, per_cu = 0;
        if (hipGetDevice(&dev) != hipSuccess || hipDeviceGetAttribute(&cus, hipDeviceAttributeMultiprocessorCount, dev) != hipSuccess) { grid = -1; return; }
        if (hipFuncSetAttribute((const void*)mk_fwd, hipFuncAttributeMaxDynamicSharedMemorySize, LDS_BYTES) != hipSuccess) { fprintf(stderr, "kernel_launch: hipFuncSetAttribute failed\n"); grid = -1; return; }
        if (hipOccupancyMaxActiveBlocksPerMultiprocessor(&per_cu, (const void*)mk_fwd, NTHREADS, LDS_BYTES) != hipSuccess || per_cu < 1) { fprintf(stderr, "kernel_launch: occupancy query says %d\n", per_cu); per_cu = 1; }
        (void)hipGetLastError();
        grid = cus;
    }
    if (grid < 0) return;
    (void)hipMemsetAsync((char*)d_ws + WS_CTL, 0, CTL_ZERO_BYTES, stream);
    Args a{};
    for (int i = 0; i < 18; ++i) a.in[i] = (const float*)d_in[i];
    a.out = (float*)d_out; a.ws = (unsigned char*)d_ws;
#if MK_ONE_LAUNCH
    a.ph_lo = 0; a.ph_hi = NPHASE;
    void* kargs[] = {&a};
    hipError_t e = hipLaunchCooperativeKernel((const void*)mk_fwd, dim3(grid), dim3(NTHREADS), kargs, LDS_BYTES, stream);
    if (e != hipSuccess) fprintf(stderr, "kernel_launch: cooperative launch failed: %s (grid %d)\n", hipGetErrorString(e), grid);
#else
    for (int ph = 0; ph < NPHASE; ++ph) { a.ph_lo = ph; a.ph_hi = ph + 1; hipLaunchKernelGGL(mk_fwd, dim3(grid), dim3(NTHREADS), LDS_BYTES, stream, a); }
#endif
}
```
